# Optimizing an MI355X kernel written in HIP

```python
import math
import jax, jax.numpy as jnp
from jax import lax
import numpy as np

D_MODEL = 1024
BATCH = 2
SEQ = 8192
DEPTH = 1

GRID_W = 64
CTX_LEN = 256
ATTN_WIDTH = 512
HGRN_WIDTH = 512
D_MIX = ATTN_WIDTH + HGRN_WIDTH
ATTN_HEADS = 4
DIFF_HEAD_DIM = 64
HGRN_HEADS = 4
HGRN_KEY_DIM = HGRN_WIDTH // HGRN_HEADS
HGRN_VAL_DIM = HGRN_WIDTH // HGRN_HEADS
CHUNK = 64
Q_BLOCK = 128
ROPE_BASE = 10000.0
ROPE_FREQS = DIFF_HEAD_DIM // 4
EPS = 1e-5
IN_WIDTHS = (ATTN_WIDTH, ATTN_WIDTH, ATTN_WIDTH, ATTN_WIDTH,
             HGRN_WIDTH, HGRN_WIDTH, HGRN_WIDTH, HGRN_WIDTH, HGRN_WIDTH)
IN_COLS = sum(IN_WIDTHS)

kernel_name = "hymba_diffattn_hgrn2_prefix_ctx_block"


def _layer_norm(x, g, b):
    xf = x.astype(jnp.float32)
    mu = jnp.mean(xf, axis=-1, keepdims=True)
    var = jnp.mean(jnp.square(xf - mu), axis=-1, keepdims=True)
    return ((xf - mu) * lax.rsqrt(var + EPS) * g.astype(jnp.float32) + b.astype(jnp.float32)).astype(x.dtype)


def _rms_norm(x, g):
    xf = x.astype(jnp.float32)
    return xf * lax.rsqrt(jnp.mean(xf * xf, axis=-1, keepdims=True) + EPS) * g.astype(jnp.float32)


def _axial_rope_tables(n_tokens):
    rows = n_tokens // GRID_W
    r, cidx = jnp.meshgrid(jnp.arange(rows, dtype=jnp.float32),
                           jnp.arange(GRID_W, dtype=jnp.float32), indexing="ij")
    pos = jnp.stack([r.reshape(-1), cidx.reshape(-1)], axis=-1)
    inv_freq = ROPE_BASE ** (-jnp.arange(ROPE_FREQS, dtype=jnp.float32) / ROPE_FREQS)
    ang = pos[:, :, None] * inv_freq
    ang = jnp.stack([ang, ang], axis=2).reshape(n_tokens, DIFF_HEAD_DIM)
    return jnp.cos(ang), jnp.sin(ang)


def _apply_rope(x, cos, sin):
    xs = x.reshape(x.shape[:-1] + (2, 2, ROPE_FREQS))
    rot = jnp.concatenate([-xs[..., 1:, :], xs[..., :1, :]], axis=-2).reshape(x.shape)
    c = cos[None, :, None, None, :].astype(x.dtype)
    s = sin[None, :, None, None, :].astype(x.dtype)
    return x * c + rot * s


def _attn_heads(aq, ak, av, rope=None):
    B, T, _ = aq.shape
    q = aq.reshape(B, T, ATTN_HEADS, 2, DIFF_HEAD_DIM)
    k = ak.reshape(B, T, ATTN_HEADS, 2, DIFF_HEAD_DIM)
    if rope is not None:
        q = _apply_rope(q, *rope)
        k = _apply_rope(k, *rope)
    v = av.reshape(B, T, ATTN_HEADS, 2 * DIFF_HEAD_DIM)
    return q.transpose(0, 2, 3, 1, 4), k.transpose(0, 2, 3, 1, 4), v.transpose(0, 2, 1, 3)


def _diff_attn(q, k, v, lam):
    s = jnp.einsum("bhmqd,bhmkd->bhmqk", q, k).astype(jnp.float32) * (1.0 / math.sqrt(DIFF_HEAD_DIM))
    p = jax.nn.softmax(s, axis=-1)
    w = p[:, :, 0] - lam * p[:, :, 1]
    return jnp.einsum("bhqk,bhkv->bhqv", w.astype(v.dtype), v)


def _attn_readout(o, gain, lambda_init, dtype):
    o = _rms_norm(o, gain) * (1.0 - lambda_init)
    B, H, T, dv = o.shape
    return o.transpose(0, 2, 1, 3).reshape(B, T, H * dv).astype(dtype)


def _to_heads(a, dh):
    B, T, _ = a.shape
    return a.reshape(B, T, -1, dh).transpose(0, 2, 1, 3)


def _hgrn_gates(z, lb):
    zf = z.astype(jnp.float32)
    log_f = jnp.log(lb + (1.0 - lb) * jax.nn.sigmoid(zf))
    k = (1.0 - lb) * jax.nn.sigmoid(-zf)
    return _to_heads(k, HGRN_KEY_DIM), _to_heads(log_f, HGRN_KEY_DIM)


def _chunk_scan(q, k, v, log_f, s0):
    B, H, T, DK = q.shape
    n_chunks = T // CHUNK

    def to_chunks(a):
        return a.reshape(B, H, n_chunks, CHUNK, a.shape[-1]).transpose(2, 0, 1, 3, 4)

    incl = jnp.tril(jnp.ones((CHUNK, CHUNK), dtype=bool))

    def step(s, inp):
        qc, kc, vc, gc = inp
        b = jnp.cumsum(gc, axis=2)
        rel = b[:, :, :, None, :] - b[:, :, None, :, :]
        decay = jnp.exp(jnp.where(incl[:, :, None], rel, -jnp.inf))
        scores = jnp.einsum("bhtk,bhsk,bhtsk->bhts", qc, kc, decay)
        o = (jnp.einsum("bhts,bhsv->bhtv", scores, vc)
             + jnp.einsum("bhtk,bhkv->bhtv", qc * jnp.exp(b), s))
        b_last = b[:, :, -1:, :]
        s_new = (jnp.exp(b_last[:, :, 0, :])[..., None] * s
                 + jnp.einsum("bhsk,bhsv->bhkv", kc * jnp.exp(b_last - b), vc))
        return s_new, o

    s_final, o = lax.scan(step, s0, (to_chunks(q), to_chunks(k), to_chunks(v), to_chunks(log_f)))
    o = o.transpose(1, 2, 0, 3, 4).reshape(B, H, T, v.shape[-1])
    return o, s_final


def _hgrn2_bidir(hq, hi, hf_fwd, hf_bwd, lb_fwd, lb_bwd, s0_fwd, s0_bwd):
    q = _to_heads(jax.nn.silu(hq.astype(jnp.float32)), HGRN_KEY_DIM)
    v = _to_heads(hi.astype(jnp.float32), HGRN_VAL_DIM)
    k_f, g_f = _hgrn_gates(hf_fwd, lb_fwd)
    k_b, g_b = _hgrn_gates(hf_bwd, lb_bwd)
    o_f, s_f = _chunk_scan(q, k_f, v, g_f, s0_fwd)
    flip = lambda a: jnp.flip(a, axis=2)
    o_b, s_b = _chunk_scan(flip(q), flip(k_b), flip(v), flip(g_b), s0_bwd)
    return o_f + flip(o_b), s_f, s_b


def _hgrn_readout(o, gain, dtype):
    o = _rms_norm(o, gain)
    B, H, T, dv = o.shape
    return o.transpose(0, 2, 1, 3).reshape(B, T, H * dv).astype(dtype)


def _project(h, w):
    p = h @ w
    idx = list(np.cumsum(IN_WIDTHS)[:-1])
    return jnp.split(p, idx, axis=-1)


def _merge(attn_o, ag, hgrn_o, hg, w_out):
    y = jnp.concatenate([attn_o * jax.nn.silu(ag), hgrn_o * jax.nn.silu(hg)], axis=-1)
    return y @ w_out


def setup_inputs(seed: int = 0) -> dict:
    key = jax.random.key(seed)
    ks = jax.random.split(key, 14)
    beta = (8.0 * DEPTH) ** -0.25
    f32 = jnp.float32
    return {
        "x": jax.random.normal(ks[0], (BATCH, SEQ, D_MODEL), f32),
        "c": jax.random.normal(ks[1], (BATCH, D_MODEL), f32),
        "ctx": jax.random.normal(ks[2], (BATCH, CTX_LEN, D_MODEL), f32),
        "c_ctx": jax.random.normal(ks[3], (D_MODEL,), f32),
        "w_ada": jax.random.normal(ks[4], (DEPTH, D_MODEL, 3 * D_MODEL), f32) * (0.5 * D_MODEL ** -0.5),
        "b_ada": jax.random.normal(ks[5], (DEPTH, 3 * D_MODEL), f32) * 0.02,
        "w_in": jax.random.normal(ks[6], (DEPTH, D_MODEL, IN_COLS), f32) * D_MODEL ** -0.5,
        "w_out": jax.random.normal(ks[7], (DEPTH, D_MIX, D_MODEL), f32) * (D_MIX ** -0.5 * beta),
        "diff_lambda": jax.random.normal(ks[8], (DEPTH, 4, DIFF_HEAD_DIM), f32) * 0.1,
        "diff_subln_gain": 1.0 + 0.02 * jax.random.normal(ks[9], (DEPTH, 2 * DIFF_HEAD_DIM), f32),
        "hgrn_lower_bound": jax.random.normal(ks[10], (2, DEPTH + 1, HGRN_WIDTH), f32) * 0.1,
        "hgrn_norm_gain": 1.0 + 0.02 * jax.random.normal(ks[11], (DEPTH, HGRN_VAL_DIM), f32),
        "ln_gain": 1.0 + 0.02 * jax.random.normal(ks[12], (DEPTH, D_MODEL), f32),
        "ln_bias": 0.02 * jax.random.normal(ks[13], (DEPTH, D_MODEL), f32),
    }


def reference(x, c, ctx, c_ctx, w_ada, b_ada, w_in, w_out, diff_lambda, diff_subln_gain,
              hgrn_lower_bound, hgrn_norm_gain, ln_gain, ln_bias):
    B, N, D = x.shape
    alpha = (2.0 * DEPTH) ** 0.25
    rope = _axial_rope_tables(N)
    lower_bounds = jnp.cumsum(jax.nn.softmax(hgrn_lower_bound.astype(jnp.float32), axis=1), axis=1)
    n_blk = N // Q_BLOCK

    for layer in range(DEPTH):
        mod = jax.nn.silu(c) @ w_ada[layer] + b_ada[layer]
        shift, scale, gate = jnp.split(mod, 3, axis=-1)
        mod_c = jax.nn.silu(c_ctx) @ w_ada[layer] + b_ada[layer]
        shift_c, scale_c, gate_c = jnp.split(mod_c, 3, axis=-1)
        h_lat = x * (1.0 + scale[:, None, :]) + shift[:, None, :]
        h_ctx = ctx * (1.0 + scale_c) + shift_c

        aq_l, ak_l, av_l, ag_l, hq_l, hi_l, hff_l, hfb_l, hg_l = _project(h_lat, w_in[layer])
        aq_c, ak_c, av_c, ag_c, hq_c, hi_c, hff_c, hfb_c, hg_c = _project(h_ctx, w_in[layer])

        lambda_init = 0.8 - 0.6 * math.exp(-0.3 * layer)
        lp = diff_lambda[layer].astype(jnp.float32)
        lam = jnp.exp(jnp.sum(lp[0] * lp[1])) - jnp.exp(jnp.sum(lp[2] * lp[3])) + lambda_init
        q_c, k_c, v_c = _attn_heads(aq_c, ak_c, av_c)
        q_l, k_l, v_l = _attn_heads(aq_l, ak_l, av_l, rope)
        k_all = jnp.concatenate([k_c, k_l], axis=3)
        v_all = jnp.concatenate([v_c, v_l], axis=2)
        q_blocks = jnp.moveaxis(q_l.reshape(B, ATTN_HEADS, 2, n_blk, Q_BLOCK, DIFF_HEAD_DIM), 3, 0)
        o_blocks = lax.map(lambda qb: _diff_attn(qb, k_all, v_all, lam), q_blocks)
        o_att_l = jnp.moveaxis(o_blocks, 0, 2).reshape(B, ATTN_HEADS, N, 2 * DIFF_HEAD_DIM)
        attn_lat = _attn_readout(o_att_l, diff_subln_gain[layer], lambda_init, x.dtype)

        lb_f, lb_b = lower_bounds[0, layer], lower_bounds[1, layer]
        s_zero = jnp.zeros((B, HGRN_HEADS, HGRN_KEY_DIM, HGRN_VAL_DIM), jnp.float32)
        o_hg_c, s_ctx_f, s_ctx_b = _hgrn2_bidir(hq_c, hi_c, hff_c, hfb_c, lb_f, lb_b, s_zero, s_zero)
        o_hg_l, _, _ = _hgrn2_bidir(hq_l, hi_l, hff_l, hfb_l, lb_f, lb_b, s_ctx_f, s_ctx_b)
        hgrn_lat = _hgrn_readout(o_hg_l, hgrn_norm_gain[layer], x.dtype)

        y_lat = _merge(attn_lat, ag_l, hgrn_lat, hg_l, w_out[layer])

        if layer < DEPTH - 1:
            attn_ctx = _attn_readout(_diff_attn(q_c, k_c, v_c, lam), diff_subln_gain[layer],
                                     lambda_init, ctx.dtype)
            hgrn_ctx = _hgrn_readout(o_hg_c, hgrn_norm_gain[layer], ctx.dtype)
            y_ctx = _merge(attn_ctx, ag_c, hgrn_ctx, hg_c, w_out[layer])
            ctx = _layer_norm(alpha * ctx + gate_c * y_ctx, ln_gain[layer], ln_bias[layer])

        x = _layer_norm(alpha * x + gate[:, None, :] * y_lat, ln_gain[layer], ln_bias[layer])
    return x
```

```cpp
#include <hip/hip_runtime.h>
#include <hip/hip_bf16.h>
#include <cstdio>
#include <cstdint>

typedef unsigned short bf16_t;
constexpr int BATCH = 2, SEQ = 8192, DM = 1024, CTX = 256, TK = SEQ + CTX, MLAT = BATCH * SEQ, MROWS = MLAT + BATCH * CTX;
constexpr int NCOLS = 4608, NH = 4, NTILE = TK / 64;
constexpr float LN_EPS = 1e-5f;
constexpr float QSCALE = 0.125f * 1.4426950408889634f;
constexpr float LAMBDA_INIT = 0.2f;
constexpr float ALPHA = 1.189207115002721f;

constexpr size_t MiB = 1u << 20;
constexpr size_t WS_CTL = 0, WS_SMALL = 1 * MiB, WS_WIN = 2 * MiB, WS_WOUT = 11 * MiB, WS_A = 13 * MiB, WS_Q = 46 * MiB, WS_K = 62 * MiB, WS_V = 79 * MiB,
                 WS_AG = 96 * MiB, WS_G = 112 * MiB, WS_ST = 178 * MiB, WS_END = 256 * MiB;
constexpr size_t DO_HQ = 0, DO_HV = 16 * MiB, DO_HG = 33 * MiB;
constexpr int SM_MOD = 0, SM_ROPE = 16384, SM_LB = 24576;

__host__ __device__ __forceinline__ unsigned f2bf(float f) { unsigned u = __builtin_bit_cast(unsigned, f); return (u + 0x7fffu + ((u >> 16) & 1u)) >> 16; }
__host__ __device__ __forceinline__ float bf2f(unsigned short h) { return __builtin_bit_cast(float, (unsigned)h << 16); }
__device__ __forceinline__ float sigmoidf_(float x) { return 1.0f / (1.0f + __expf(-x)); }
__device__ __forceinline__ float siluf_(float x) { return x * sigmoidf_(x); }

__host__ __device__ __forceinline__ void row_bj(int r, int& b, int& j) { if (r < MLAT) { b = r >> 13; j = CTX + (r & (SEQ - 1)); } else { const int rr = r - MLAT; b = rr >> 8; j = rr & 255; } }
__host__ __device__ __forceinline__ int bj_row(int b, int j) { return j < CTX ? MLAT + b * CTX + j : b * SEQ + (j - CTX); }
__host__ __device__ __forceinline__ int dpos(int d) { const int p = d & 31; return (d & 32) + 8 * ((p >> 2) & 3) + 4 * (p >> 4) + (p & 3); }
__host__ __device__ __forceinline__ size_t idxQ(int b, int h, int m, int t, int s) { return ((size_t)(((b * NH + h) * 2 + m) * SEQ + t)) * 64 + s; }
__host__ __device__ __forceinline__ size_t idxK(int b, int h, int m, int j, int s) { return ((size_t)(((b * NH + h) * 2 + m) * NTILE + (j >> 6))) * 4096 + (s >> 3) * 512 + (j & 63) * 8 + (s & 7); }
__host__ __device__ __forceinline__ size_t idxV(int b, int h, int j, int dv) { return ((size_t)((b * NH + h) * NTILE + (j >> 6))) * 8192 + (dv >> 5) * 2048 + ((j >> 4) & 3) * 512 + (j & 15) * 32 + (dv & 31); }

__global__ void __launch_bounds__(256) nv_mod(const float* c, const float* c_ctx, const float* w_ada, const float* b_ada, float* mod) {
    const int n = blockIdx.x * 256 + threadIdx.x; if (n >= 3072) return;
    float a0 = 0.f, a1 = 0.f, a2 = 0.f;
    for (int k = 0; k < DM; ++k) { const float w = w_ada[(size_t)k * 3072 + n]; a0 += siluf_(c[k]) * w; a1 += siluf_(c[DM + k]) * w; a2 += siluf_(c_ctx[k]) * w; }
    const float bb = b_ada[n]; mod[n] = a0 + bb; mod[3072 + n] = a1 + bb; mod[6144 + n] = a2 + bb;
}
__global__ void __launch_bounds__(256) nv_small(const float* hlb, float* small) {
    const int i = blockIdx.x * 256 + threadIdx.x;
    if (i < 2048) {
        const int pos = i >> 4, f = i & 15;
        float fr = (f & 3) == 0 ? 1.0f : (f & 3) == 1 ? 0.5623413251903491f : (f & 3) == 2 ? 0.31622776601683794f : 0.1778279410038923f;
        const float dec = (f >> 2) == 0 ? 1.0f : (f >> 2) == 1 ? 0.1f : (f >> 2) == 2 ? 0.01f : 0.001f;
        const float ang_f = (float)pos * (fr * dec);
        double a = (double)ang_f; const double TWO_PI = 6.283185307179586476925; const double n = __builtin_rint(a / TWO_PI); double r = a - n * TWO_PI;
        double r2 = r * r, sn = 0.0, cs = 0.0, ts = r, tc = 1.0;
        for (int k = 0; k < 14; ++k) { cs += tc; sn += ts; tc = -tc * r2 / (double)((2 * k + 1) * (2 * k + 2)); ts = -ts * r2 / (double)((2 * k + 2) * (2 * k + 3)); }
        small[SM_ROPE + i * 2] = (float)cs; small[SM_ROPE + i * 2 + 1] = (float)sn;
    } else if (i < 2048 + 1024) {
        const int q = i - 2048, d = q >> 9, e = q & 511;
        const float a0 = hlb[d * 1024 + e], a1 = hlb[d * 1024 + 512 + e];
        small[SM_LB + q] = 1.0f / (1.0f + __expf(a1 - a0));
    }
}
__global__ void __launch_bounds__(256) nv_modulate(const float* x, const float* ctx, const float* mod, bf16_t* A) {
    const int r = blockIdx.x; const float* src; const float* md;
    if (r < MLAT) { src = x + (size_t)r * DM; md = mod + (r >> 13) * 3072; } else { src = ctx + (size_t)(r - MLAT) * DM; md = mod + 2 * 3072; }
    for (int k = threadIdx.x; k < DM; k += 256) A[(size_t)r * DM + k] = (bf16_t)f2bf(src[k] * (1.0f + md[1024 + k]) + md[k]);
}
__global__ void __launch_bounds__(256) nv_gemm(const bf16_t* A, const float* W, int ldw, int c0, float* C) {
    __shared__ float As[16][68]; __shared__ float Bs[16][64];
    const int tx = threadIdx.x & 15, ty = threadIdx.x >> 4; const int row0 = blockIdx.y * 64, col0 = blockIdx.x * 64;
    float acc[4][4];
#pragma unroll
    for (int i = 0; i < 4; ++i)
#pragma unroll
        for (int j = 0; j < 4; ++j) acc[i][j] = 0.f;
    for (int k0 = 0; k0 < DM; k0 += 16) {
#pragma unroll
        for (int i = 0; i < 4; ++i) { const int e = threadIdx.x + i * 256; const int r = e >> 4, kk = e & 15; As[kk][r] = bf2f(A[(size_t)(row0 + r) * DM + k0 + kk]); }
#pragma unroll
        for (int i = 0; i < 4; ++i) { const int e = threadIdx.x + i * 256; const int kk = e >> 6, cc = e & 63; Bs[kk][cc] = W[(size_t)(k0 + kk) * ldw + c0 + col0 + cc]; }
        __syncthreads();
#pragma unroll
        for (int kk = 0; kk < 16; ++kk) {
            float a[4], b[4];
#pragma unroll
            for (int i = 0; i < 4; ++i) { a[i] = As[kk][ty * 4 + i]; b[i] = Bs[kk][tx * 4 + i]; }
#pragma unroll
            for (int i = 0; i < 4; ++i)
#pragma unroll
                for (int j = 0; j < 4; ++j) acc[i][j] += a[i] * b[j];
        }
        __syncthreads();
    }
#pragma unroll
    for (int i = 0; i < 4; ++i)
#pragma unroll
        for (int j = 0; j < 4; ++j) C[(size_t)(row0 + ty * 4 + i) * 512 + col0 + tx * 4 + j] = acc[i][j];
}
struct Bufs { bf16_t *Q, *K, *V, *AG, *HQ, *HV, *HG; float* G; const float* small; };
__global__ void __launch_bounds__(256) nv_post(const float* TMP, int grp, Bufs B) {
    const int r = blockIdx.x; int b, j; row_bj(r, b, j); const bool lat = r < MLAT; const int t = j - CTX;
    const float* p = TMP + (size_t)r * 512;
    for (int c = threadIdx.x; c < 512; c += 256) {
        const float v = p[c];
        if (grp == 0 || grp == 1) {
            const int h = c >> 7, m = (c >> 6) & 1, d = c & 63; float o = v;
            if (lat) { const int axis = d >> 5, half = (d >> 4) & 1, f = d & 15; const int pos = axis == 0 ? (t >> 6) : (t & 63);
                const float cs = B.small[SM_ROPE + (pos * 16 + f) * 2], sn = B.small[SM_ROPE + (pos * 16 + f) * 2 + 1];
                const float rot = half == 0 ? -p[c + 16] : p[c - 16]; o = v * cs + rot * sn; }
            if (grp == 0) { if (lat) B.Q[idxQ(b, h, m, t, dpos(d))] = (bf16_t)f2bf(o * QSCALE); }
            else B.K[idxK(b, h, m, j, dpos(d))] = (bf16_t)f2bf(o);
        } else if (grp == 2) { B.V[idxV(b, c >> 7, j, c & 127)] = (bf16_t)f2bf(v); }
        else if (grp == 3) { if (lat) B.AG[(size_t)r * 512 + c] = (bf16_t)f2bf(siluf_(v)); }
        else if (grp == 4) { if (lat) B.HQ[(size_t)r * 512 + c] = (bf16_t)f2bf(siluf_(v)); }
        else if (grp == 5) { B.HV[(size_t)r * 512 + c] = (bf16_t)f2bf(v); }
        else if (grp == 6 || grp == 7) { const int d = grp - 6; const float lb = B.small[SM_LB + d * 512 + c]; B.G[(size_t)r * 1024 + d * 512 + c] = __logf(lb + (1.0f - lb) * sigmoidf_(v)); }
        else { if (lat) B.HG[(size_t)r * 512 + c] = (bf16_t)f2bf(siluf_(v)); }
    }
}
__global__ void __launch_bounds__(256) nv_attn(Bufs B, const float* dlam, const float* gain, bf16_t* Y) {
    extern __shared__ __attribute__((aligned(16))) float dynlds[];
    float (*sc)[TK] = (float (*)[TK])dynlds; float* qs = dynlds + 2 * TK; float* red = qs + 128; float* ob = red + 8;
    const int id = blockIdx.x; const int t = id & (SEQ - 1), h = (id >> 13) & 3, b = id >> 15; const int tid = threadIdx.x, lane = tid & 63, wv = tid >> 6;
    if (tid < 128) qs[tid] = bf2f(B.Q[idxQ(b, h, tid >> 6, t, tid & 63)]);
    __syncthreads();
    float mx0 = -1e30f, mx1 = -1e30f;
    for (int j = tid; j < TK; j += 256) {
        float s0 = 0.f, s1 = 0.f;
        for (int s = 0; s < 64; ++s) { s0 += qs[s] * bf2f(B.K[idxK(b, h, 0, j, s)]); s1 += qs[64 + s] * bf2f(B.K[idxK(b, h, 1, j, s)]); }
        sc[0][j] = s0; sc[1][j] = s1; mx0 = fmaxf(mx0, s0); mx1 = fmaxf(mx1, s1);
    }
    for (int o = 32; o; o >>= 1) { mx0 = fmaxf(mx0, __shfl_xor(mx0, o)); mx1 = fmaxf(mx1, __shfl_xor(mx1, o)); }
    if (lane == 0) { red[wv] = mx0; red[4 + wv] = mx1; }
    __syncthreads();
    mx0 = fmaxf(fmaxf(red[0], red[1]), fmaxf(red[2], red[3])); mx1 = fmaxf(fmaxf(red[4], red[5]), fmaxf(red[6], red[7]));
    __syncthreads();
    float l0 = 0.f, l1 = 0.f;
    for (int j = tid; j < TK; j += 256) { const float p0 = exp2f(sc[0][j] - mx0), p1 = exp2f(sc[1][j] - mx1); sc[0][j] = p0; sc[1][j] = p1; l0 += p0; l1 += p1; }
    for (int o = 32; o; o >>= 1) { l0 += __shfl_xor(l0, o); l1 += __shfl_xor(l1, o); }
    if (lane == 0) { red[wv] = l0; red[4 + wv] = l1; }
    __syncthreads();
    l0 = (red[0] + red[1]) + (red[2] + red[3]); l1 = (red[4] + red[5]) + (red[6] + red[7]);
    float s01 = 0.f, s23 = 0.f;
    for (int i = 0; i < 64; ++i) { s01 += dlam[i] * dlam[64 + i]; s23 += dlam[128 + i] * dlam[192 + i]; }
    const float lam = __expf(s01) - __expf(s23) + LAMBDA_INIT;
    const float c0 = 1.0f / l0, c1 = lam / l1;
    const int dv = tid & 127, hf = tid >> 7; float acc = 0.f;
    for (int j = hf * (TK / 2); j < (hf + 1) * (TK / 2); ++j) acc += (sc[0][j] * c0 - sc[1][j] * c1) * bf2f(B.V[idxV(b, h, j, dv)]);
    ob[tid] = acc;
    __syncthreads();
    if (tid < 128) {
        const float o = ob[tid] + ob[128 + tid]; float ss = o * o;
        for (int off = 32; off; off >>= 1) ss += __shfl_xor(ss, off);
        if (lane == 0) red[wv] = ss;
        ob[tid] = o;
    }
    __syncthreads();
    if (tid < 128) {
        const float ms = (red[0] + red[1]) * (1.0f / 128.0f); const float r = rsqrtf(ms + LN_EPS);
        const size_t row = (size_t)(b * SEQ + t);
        const float y = ob[tid] * r * gain[tid] * (1.0f - LAMBDA_INIT) * bf2f(B.AG[row * 512 + h * 128 + tid]);
        Y[row * DM + h * 128 + tid] = (bf16_t)f2bf(y);
    }
}
__global__ void __launch_bounds__(64) nv_hgrn(Bufs B, float* OF, float* OB) {
    const int id = blockIdx.x; const int v = id & 127, dir = (id >> 7) & 1, h = (id >> 8) & 3, b = id >> 10; const int lane = threadIdx.x;
    float S0 = 0.f, S1 = 0.f; float* O = dir ? OB : OF;
    for (int step = 0; step < TK; ++step) {
        const int j = dir == 0 ? step : (step < CTX ? CTX - 1 - step : TK - 1 - (step - CTX));
        const int r = bj_row(b, j);
        const float* g = B.G + (size_t)r * 1024 + dir * 512 + h * 128;
        const float f0 = __expf(g[lane]), f1 = __expf(g[lane + 64]);
        const float vv = bf2f(B.HV[(size_t)r * 512 + h * 128 + v]);
        S0 = f0 * S0 + (1.0f - f0) * vv; S1 = f1 * S1 + (1.0f - f1) * vv;
        if (j >= CTX) {
            const float q0 = bf2f(B.HQ[(size_t)r * 512 + h * 128 + lane]), q1 = bf2f(B.HQ[(size_t)r * 512 + h * 128 + lane + 64]);
            float p = S0 * q0 + S1 * q1;
            for (int off = 32; off; off >>= 1) p += __shfl_xor(p, off);
            if (lane == 0) O[(size_t)r * 512 + h * 128 + v] = p;
        }
    }
}
__global__ void __launch_bounds__(64) nv_hgrn_out(Bufs B, const float* OF, const float* OB, const float* gain, bf16_t* Y) {
    const int r = blockIdx.x >> 2, h = blockIdx.x & 3, lane = threadIdx.x;
    const size_t o = (size_t)r * 512 + h * 128;
    const float a = OF[o + lane] + OB[o + lane], c = OF[o + 64 + lane] + OB[o + 64 + lane];
    float ss = a * a + c * c;
    for (int off = 32; off; off >>= 1) ss += __shfl_xor(ss, off);
    const float rr = rsqrtf(ss * (1.0f / 128.0f) + LN_EPS);
    Y[(size_t)r * DM + 512 + h * 128 + lane] = (bf16_t)f2bf(a * rr * gain[lane] * bf2f(B.HG[o + lane]));
    Y[(size_t)r * DM + 512 + h * 128 + 64 + lane] = (bf16_t)f2bf(c * rr * gain[64 + lane] * bf2f(B.HG[o + 64 + lane]));
}
__global__ void __launch_bounds__(256) nv_out(const bf16_t* Y, const float* w_out, const float* x, const float* mod, const float* lng, const float* lnb, float* out) {
    __shared__ float ys[DM]; __shared__ float red[8];
    const int r = blockIdx.x, tid = threadIdx.x, lane = tid & 63, wv = tid >> 6;
    for (int k = tid; k < DM; k += 256) ys[k] = bf2f(Y[(size_t)r * DM + k]);
    __syncthreads();
    float acc[4] = {0.f, 0.f, 0.f, 0.f};
    for (int k = 0; k < DM; ++k) { const float y = ys[k];
#pragma unroll
        for (int i = 0; i < 4; ++i) acc[i] += y * w_out[(size_t)k * DM + tid + 256 * i]; }
    const float* gate = mod + (r >> 13) * 3072 + 2048;
    float z[4], s = 0.f;
#pragma unroll
    for (int i = 0; i < 4; ++i) { const int n = tid + 256 * i; z[i] = ALPHA * x[(size_t)r * DM + n] + gate[n] * acc[i]; s += z[i]; }
    for (int off = 32; off; off >>= 1) s += __shfl_xor(s, off);
    if (lane == 0) red[wv] = s;
    __syncthreads();
    const float mean = ((red[0] + red[1]) + (red[2] + red[3])) * (1.0f / DM);
    float q = 0.f;
#pragma unroll
    for (int i = 0; i < 4; ++i) { const float d = z[i] - mean; q += d * d; }
    for (int off = 32; off; off >>= 1) q += __shfl_xor(q, off);
    if (lane == 0) red[4 + wv] = q;
    __syncthreads();
    const float var = ((red[4] + red[5]) + (red[6] + red[7])) * (1.0f / DM); const float rstd = rsqrtf(var + LN_EPS);
#pragma unroll
    for (int i = 0; i < 4; ++i) { const int n = tid + 256 * i; out[(size_t)r * DM + n] = (z[i] - mean) * rstd * lng[n] + lnb[n]; }
}

extern "C" void kernel_launch(void* const* d_in, const int* in_sizes, int n_in, void* d_out, int out_size, void* d_ws, size_t ws_size, hipStream_t stream) {
    const float* x = (const float*)d_in[0]; const float* c = (const float*)d_in[1]; const float* ctx = (const float*)d_in[2]; const float* c_ctx = (const float*)d_in[3];
    const float* w_ada = (const float*)d_in[4]; const float* b_ada = (const float*)d_in[5]; const float* w_in = (const float*)d_in[6]; const float* w_out = (const float*)d_in[7];
    const float* dlam = (const float*)d_in[8]; const float* dgain = (const float*)d_in[9]; const float* hlb = (const float*)d_in[10]; const float* hgain = (const float*)d_in[11];
    const float* lng = (const float*)d_in[12]; const float* lnb = (const float*)d_in[13];
    if (ws_size < WS_END) { fprintf(stderr, "ws too small: %zu\n", ws_size); return; }
    unsigned char* ws = (unsigned char*)d_ws; unsigned char* dob = (unsigned char*)d_out;
    float* small = (float*)(ws + WS_SMALL); float* mod = small + SM_MOD;
    bf16_t* A = (bf16_t*)(ws + WS_A);
    Bufs B; B.Q = (bf16_t*)(ws + WS_Q); B.K = (bf16_t*)(ws + WS_K); B.V = (bf16_t*)(ws + WS_V); B.AG = (bf16_t*)(ws + WS_AG); B.G = (float*)(ws + WS_G);
    B.HQ = (bf16_t*)(dob + DO_HQ); B.HV = (bf16_t*)(dob + DO_HV); B.HG = (bf16_t*)(dob + DO_HG); B.small = small;
    float* TMP = (float*)(ws + WS_ST);
    float* OF = (float*)(ws + WS_ST); float* OB = (float*)(ws + WS_ST + 32 * MiB);
    bf16_t* Y = A;
    nv_mod<<<12, 256, 0, stream>>>(c, c_ctx, w_ada, b_ada, mod);
    nv_small<<<12, 256, 0, stream>>>(hlb, small);
    nv_modulate<<<MROWS, 256, 0, stream>>>(x, ctx, mod, A);
    for (int g = 0; g < 9; ++g) {
        nv_gemm<<<dim3(8, MROWS / 64), 256, 0, stream>>>(A, w_in, NCOLS, g * 512, TMP);
        nv_post<<<MROWS, 256, 0, stream>>>(TMP, g, B);
    }
    nv_hgrn<<<BATCH * NH * 2 * 128, 64, 0, stream>>>(B, OF, OB);
    constexpr int ATT_LDS = (2 * TK + 128 + 8 + 256) * 4;
    (void)hipFuncSetAttribute((const void*)nv_attn, hipFuncAttributeMaxDynamicSharedMemorySize, ATT_LDS);
    nv_attn<<<BATCH * NH * SEQ, 256, ATT_LDS, stream>>>(B, dlam, dgain, Y);
    nv_hgrn_out<<<MLAT * NH, 64, 0, stream>>>(B, OF, OB, hgain, Y);
    nv_out<<<MLAT, 256, 0, stream>>>(Y, w_out, x, mod, lng, lnb, (float*)d_out);
}
```
